# Optimizing an MI355X kernel written in HIP

```python
import math
import jax, jax.numpy as jnp
from jax import lax
import numpy as np

D_MODEL = 1024
BATCH = 2
SEQ = 8192
DEPTH = 1

DA_HEADS = 4
DA_QK_DIM = 64
DA_V_DIM = 2 * DA_QK_DIM
DA_QK_WIDTH = DA_HEADS * 2 * DA_QK_DIM
DA_WIDTH = DA_HEADS * DA_V_DIM
DN_HEADS = 4
DN_K_DIM = 128
DN_V_DIM = 128
DN_WIDTH = DN_HEADS * DN_V_DIM
DN_QKV_WIDTH = DN_HEADS * (2 * DN_K_DIM + DN_V_DIM)
CONV_WIDTH = 4
CHUNK = 64
MIX_WIDTH = DA_WIDTH + DN_WIDTH
D_FF = 4 * D_MODEL
Q_BLOCK = 128
EPS = 1e-6
IN_WIDTH = 2 * DA_QK_WIDTH + DA_WIDTH + DN_QKV_WIDTH + DN_WIDTH + 2 * DN_HEADS
SPLIT_1 = DA_QK_WIDTH
SPLIT_2 = SPLIT_1 + DA_QK_WIDTH
SPLIT_3 = SPLIT_2 + DA_WIDTH
SPLIT_4 = SPLIT_3 + DN_QKV_WIDTH
SPLIT_5 = SPLIT_4 + DN_WIDTH
SPLIT_6 = SPLIT_5 + DN_HEADS

kernel_name = "hymba_diffattn_gdn_sqrelu"


def rms_norm(x, w):
    xf = x.astype(jnp.float32)
    y = xf * lax.rsqrt(jnp.mean(xf * xf, axis=-1, keepdims=True) + EPS)
    return (y * w.astype(jnp.float32)).astype(x.dtype)


def l2_norm(x):
    xf = x.astype(jnp.float32)
    return xf * lax.rsqrt(jnp.sum(xf * xf, axis=-1, keepdims=True) + EPS)


def diff_attention(q, k, v, lam):
    B, S = q.shape[0], q.shape[1]
    nb = S // Q_BLOCK
    scale = DA_QK_DIM ** -0.5
    k_pos = jnp.arange(S)
    q_blocks = jnp.moveaxis(q.reshape(B, nb, Q_BLOCK, DA_HEADS, 2, DA_QK_DIM), 1, 0)
    starts = jnp.arange(nb) * Q_BLOCK

    def block(args):
        qb, start = args
        s = jnp.einsum('bqhcd,bkhcd->bhcqk', qb, k,
                       preferred_element_type=jnp.float32) * scale
        causal = (start + jnp.arange(Q_BLOCK))[:, None] >= k_pos[None, :]
        s = jnp.where(causal, s, jnp.finfo(jnp.float32).min)
        p = jax.nn.softmax(s, axis=-1)
        a = p[:, :, 0] - lam * p[:, :, 1]
        return jnp.einsum('bhqk,bkhe->bqhe', a.astype(v.dtype), v)

    out = lax.map(block, (q_blocks, starts))
    return jnp.moveaxis(out, 0, 1).reshape(B, S, DA_HEADS, DA_V_DIM)


def causal_conv_silu(x, w):
    C = x.shape[-1]
    y = lax.conv_general_dilated(
        x, w[:, None, :].astype(x.dtype), window_strides=(1,),
        padding=[(CONV_WIDTH - 1, 0)], dimension_numbers=('NWC', 'WIO', 'NWC'),
        feature_group_count=C)
    return jax.nn.silu(y)


def gated_delta_rule(q, k, v, g, beta):
    B, S, H, Dk = k.shape
    Dv = v.shape[-1]
    n = S // CHUNK

    def chunks(t):
        t = jnp.moveaxis(t.astype(jnp.float32), 2, 1)
        return t.reshape((B, H, n, CHUNK) + t.shape[3:])

    q, k, v, g, beta = (chunks(q * Dk ** -0.5), chunks(k), chunks(v), chunks(g), chunks(beta))
    g = jnp.cumsum(g, axis=-1)
    tri = jnp.tril(jnp.ones((CHUNK, CHUNK), dtype=bool))
    strict = jnp.tril(jnp.ones((CHUNK, CHUNK), dtype=bool), -1)
    gdiff = g[..., :, None] - g[..., None, :]
    decay = jnp.where(tri, jnp.exp(jnp.where(tri, gdiff, 0.0)), 0.0)
    k_beta = k * beta[..., None]
    v_beta = v * beta[..., None]
    Lmat = jnp.where(strict, jnp.einsum('bhncd,bhnjd->bhncj', k_beta, k) * decay, 0.0)
    rhs = jnp.concatenate([v_beta, k_beta * jnp.exp(g)[..., None]], axis=-1)
    sol = lax.linalg.triangular_solve(Lmat, rhs, left_side=True, lower=True, unit_diagonal=True)
    u, w = sol[..., :Dv], sol[..., Dv:]
    qk = jnp.where(tri, jnp.einsum('bhncd,bhnjd->bhncj', q, k) * decay, 0.0)
    xs = tuple(jnp.moveaxis(t, 2, 0) for t in (q, k, u, w, qk, g))

    def step(state, inp):
        q_c, k_c, u_c, w_c, qk_c, g_c = inp
        v_new = u_c - jnp.einsum('bhcd,bhde->bhce', w_c, state)
        o = (jnp.einsum('bhcd,bhde->bhce', q_c * jnp.exp(g_c)[..., None], state)
             + jnp.einsum('bhcj,bhje->bhce', qk_c, v_new))
        g_last = g_c[..., -1]
        k_dec = k_c * jnp.exp(g_last[..., None] - g_c)[..., None]
        state = state * jnp.exp(g_last)[..., None, None] + jnp.einsum('bhcd,bhce->bhde', k_dec, v_new)
        return state, o

    state0 = jnp.zeros((B, H, Dk, Dv), jnp.float32)
    _, o = lax.scan(step, state0, xs)
    o = jnp.moveaxis(o, 0, 2).reshape(B, H, S, Dv)
    return jnp.moveaxis(o, 1, 2)


def setup_inputs(seed: int = 0) -> dict:
    key = jax.random.key(seed)
    ks = jax.random.split(key, 20)
    f32 = jnp.float32
    nrm = lambda k, shape, s: jax.random.normal(k, shape, f32) * s
    dt = jnp.exp(jax.random.uniform(ks[12], (DEPTH, DN_HEADS), f32, math.log(1e-3), math.log(1e-1)))
    return {
        "x": jax.random.normal(ks[0], (BATCH, SEQ, D_MODEL), f32),
        "norm1_w": 1.0 + nrm(ks[1], (DEPTH, D_MODEL), 0.02),
        "w_in": nrm(ks[2], (DEPTH, D_MODEL, IN_WIDTH), D_MODEL ** -0.5),
        "lambda_q1": nrm(ks[3], (DEPTH, DA_QK_DIM), 0.1),
        "lambda_k1": nrm(ks[4], (DEPTH, DA_QK_DIM), 0.1),
        "lambda_q2": nrm(ks[5], (DEPTH, DA_QK_DIM), 0.1),
        "lambda_k2": nrm(ks[6], (DEPTH, DA_QK_DIM), 0.1),
        "q_norm_w": 1.0 + nrm(ks[7], (DEPTH, DA_QK_DIM), 0.02),
        "k_norm_w": 1.0 + nrm(ks[8], (DEPTH, DA_QK_DIM), 0.02),
        "da_out_norm_w": 1.0 + nrm(ks[9], (DEPTH, DA_V_DIM), 0.02),
        "conv_w": nrm(ks[10], (DEPTH, CONV_WIDTH, DN_QKV_WIDTH), CONV_WIDTH ** -0.5),
        "A_log": jnp.log(jax.random.uniform(ks[11], (DEPTH, DN_HEADS), f32, 1.0, 16.0)),
        "dt_bias": dt + jnp.log(-jnp.expm1(-dt)),
        "dn_out_norm_w": 1.0 + nrm(ks[13], (DEPTH, DN_V_DIM), 0.02),
        "w_out": nrm(ks[14], (DEPTH, MIX_WIDTH, D_MODEL), MIX_WIDTH ** -0.5),
        "norm2_w": 1.0 + nrm(ks[15], (DEPTH, D_MODEL), 0.02),
        "w_up": nrm(ks[16], (DEPTH, D_MODEL, D_FF), D_MODEL ** -0.5),
        "w_down": nrm(ks[17], (DEPTH, D_FF, D_MODEL), D_FF ** -0.5),
    }


def reference(x, norm1_w, w_in, lambda_q1, lambda_k1, lambda_q2, lambda_k2, q_norm_w, k_norm_w,
              da_out_norm_w, conv_w, A_log, dt_bias, dn_out_norm_w, w_out, norm2_w, w_up, w_down):
    B, S = x.shape[0], x.shape[1]
    for l in range(DEPTH):
        h = rms_norm(x, norm1_w[l])
        proj = h @ w_in[l]
        da_q, da_k, da_v, dn_qkv, dn_z, dn_a, dn_b = jnp.split(
            proj, [SPLIT_1, SPLIT_2, SPLIT_3, SPLIT_4, SPLIT_5, SPLIT_6], axis=-1)

        da_q = rms_norm(da_q.reshape(B, S, DA_HEADS, 2, DA_QK_DIM), q_norm_w[l])
        da_k = rms_norm(da_k.reshape(B, S, DA_HEADS, 2, DA_QK_DIM), k_norm_w[l])
        da_v = da_v.reshape(B, S, DA_HEADS, DA_V_DIM)
        lam_init = 0.8 - 0.6 * math.exp(-0.3 * l)
        lam = (jnp.exp(jnp.sum(lambda_q1[l].astype(jnp.float32) * lambda_k1[l].astype(jnp.float32)))
               - jnp.exp(jnp.sum(lambda_q2[l].astype(jnp.float32) * lambda_k2[l].astype(jnp.float32)))
               + lam_init)
        da_o = diff_attention(da_q, da_k, da_v, lam)
        da_o = rms_norm(da_o, da_out_norm_w[l]) * (1.0 - lam_init)

        dn_qkv = causal_conv_silu(dn_qkv, conv_w[l])
        dn_q, dn_k, dn_v = jnp.split(dn_qkv, [DN_HEADS * DN_K_DIM, 2 * DN_HEADS * DN_K_DIM], axis=-1)
        dn_q = l2_norm(dn_q.reshape(B, S, DN_HEADS, DN_K_DIM))
        dn_k = l2_norm(dn_k.reshape(B, S, DN_HEADS, DN_K_DIM))
        dn_v = dn_v.reshape(B, S, DN_HEADS, DN_V_DIM)
        beta = jax.nn.sigmoid(dn_b.astype(jnp.float32))
        g = -jnp.exp(A_log[l].astype(jnp.float32)) * jax.nn.softplus(
            dn_a.astype(jnp.float32) + dt_bias[l].astype(jnp.float32))
        dn_o = gated_delta_rule(dn_q, dn_k, dn_v, g, beta).astype(x.dtype)
        dn_o = rms_norm(dn_o, dn_out_norm_w[l]) * jax.nn.silu(dn_z.reshape(B, S, DN_HEADS, DN_V_DIM))

        mix = jnp.concatenate([da_o.reshape(B, S, DA_WIDTH), dn_o.reshape(B, S, DN_WIDTH)], axis=-1)
        x = x + mix @ w_out[l]

        h = rms_norm(x, norm2_w[l])
        x = x + jnp.square(jax.nn.relu(h @ w_up[l])) @ w_down[l]
    return x
```

```cpp
#include <hip/hip_runtime.h>
#include <hip/hip_bf16.h>
#include <cstdio>
#include <cstdint>
#include <cmath>

namespace pg8 {
#define PG8_LAS __attribute__((address_space(3)))
typedef unsigned short bf16_t;
typedef short bf16x8 __attribute__((ext_vector_type(8)));
typedef float f32x4 __attribute__((ext_vector_type(4)));
typedef unsigned u32x4 __attribute__((ext_vector_type(4)));
constexpr int BM = 256, BK = 64, HALF = 128, HTB = HALF * BK * 2  , STAGE_BYTES = 8 * HTB, NXCD = 8, WGM = 8;

__host__ __device__ __forceinline__ int lds_byte(int r, int c) { const int st = (r >> 4) * 2 + (c >> 5), rr = r & 15, cc = c & 31, ob = rr * 64 + cc * 2; return st * 1024 + (ob ^ (((ob >> 9) & 1) << 5)); }
__host__ __device__ __forceinline__ void stage_rc(int b, int& R, int& C) { const int st = b / 1024, sb = b % 1024, swz = sb ^ (((sb >> 9) & 1) << 5); R = (st >> 1) * 16 + swz / 64; C = (st & 1) * 32 + (swz % 64) / 2; }
__host__ __device__ __forceinline__ int perm32(int rho) { const int n = rho >> 4, i = rho & 15; return 8 * (i >> 2) + 4 * n + (i & 3); }

struct Unit { int pm, pn; };
struct Gemm { const bf16_t* A; const bf16_t* Bt; int M, N, K; };

struct StaticOrder {
    int nM, nN, nwg, G, c;
    __host__ __device__ void init(int M, int N, int G_, int c_) { nM = M / BM; nN = N / BM; nwg = nM * nN; G = G_; c = c_; }
    __host__ __device__ bool next(int i, Unit& u) const {
        const long L = (long)i * G + c; if (L >= nwg) return false;
        int wgid = (int)L; { const int q = nwg / NXCD, r = nwg % NXCD, xcd = wgid % NXCD, off = wgid / NXCD; wgid = (xcd < r ? xcd * (q + 1) : r * (q + 1) + (xcd - r) * q) + off; }
        const int nig = WGM * nN, gid = wgid / nig, fm = gid * WGM, gsz = (nM - fm) < WGM ? (nM - fm) : WGM;
        u.pm = fm + ((wgid % nig) % gsz); u.pn = (wgid % nig) / gsz; return true;
    }
    __device__ __forceinline__ void a_ready(const Unit&) const {}
    __device__ __forceinline__ void done(const Unit&) const {}
};

__device__ __forceinline__ unsigned cvt_pk_bf16(float lo, float hi) { unsigned r; asm volatile("v_cvt_pk_bf16_f32 %0, %1, %2" : "=v"(r) : "v"(lo), "v"(hi)); return r; }
__device__ __forceinline__ u32x4 pack8(const f32x4 v0, const f32x4 v1) { u32x4 w; w.x = cvt_pk_bf16(v0[0], v0[1]); w.y = cvt_pk_bf16(v0[2], v0[3]); w.z = cvt_pk_bf16(v1[0], v1[1]); w.w = cvt_pk_bf16(v1[2], v1[3]); return w; }
__device__ __forceinline__ float dot4(const f32x4 a) { return (a[0] * a[0] + a[1] * a[1]) + (a[2] * a[2] + a[3] * a[3]); }

struct EpiProj {
    static constexpr bool PERM = true, AFTER_DRAIN = false;
    bf16_t *QA, *KA, *VA, *DNRAW, *Z; float* AB; const float *qw, *kw; float c2, eps;
    __device__ __forceinline__ void operator()(const f32x4 (&acc)[2][2][4][2], const Unit& u, int wr, int wc, int fr, int fq) const {
        const int pn = u.pn, row0 = u.pm * BM + wr * 64 + fr, cw = wc * 64 + 8 * fq;
        if (pn < 4) {
            bf16_t* base = (pn < 2 ? QA : KA) + (pn & 1) * 256 + cw; const float* nw = pn < 2 ? qw : kw; const float sc = pn < 2 ? c2 : 1.f;
            f32x4 w[2][2];
#pragma unroll
            for (int bj = 0; bj < 2; ++bj)
#pragma unroll
                for (int n = 0; n < 2; ++n) w[bj][n] = *(const f32x4*)(nw + bj * 32 + 8 * fq + 4 * n);
#pragma unroll
            for (int ai = 0; ai < 2; ++ai)
#pragma unroll
                for (int m = 0; m < 4; ++m) {
                    float ss = (dot4(acc[ai][0][m][0]) + dot4(acc[ai][0][m][1])) + (dot4(acc[ai][1][m][0]) + dot4(acc[ai][1][m][1]));
                    ss += __shfl_xor(ss, 16); ss += __shfl_xor(ss, 32);
                    const float r = sc / sqrtf(ss * (1.f / 64.f) + eps);
                    bf16_t* rowp = base + (size_t)(row0 + ai * HALF + m * 16) * 512;
#pragma unroll
                    for (int bj = 0; bj < 2; ++bj) *(u32x4*)(rowp + bj * 32) = pack8(acc[ai][bj][m][0] * r * w[bj][0], acc[ai][bj][m][1] * r * w[bj][1]);
                }
        } else if (pn < 14) {
            bf16_t* base; int ldc;
            if (pn < 6) { base = VA + (pn - 4) * 256; ldc = 512; } else if (pn < 12) { base = DNRAW + (pn - 6) * 256; ldc = 1536; } else { base = Z + (pn - 12) * 256; ldc = 512; }
            base += cw;
#pragma unroll
            for (int ai = 0; ai < 2; ++ai)
#pragma unroll
                for (int m = 0; m < 4; ++m) { bf16_t* rowp = base + (size_t)(row0 + ai * HALF + m * 16) * ldc;
#pragma unroll
                    for (int bj = 0; bj < 2; ++bj) *(u32x4*)(rowp + bj * 32) = pack8(acc[ai][bj][m][0], acc[ai][bj][m][1]); }
        } else {
            if (wc == 0 && fq == 0) {
#pragma unroll
                for (int ai = 0; ai < 2; ++ai)
#pragma unroll
                    for (int m = 0; m < 4; ++m) { float* rowp = AB + (size_t)(row0 + ai * HALF + m * 16) * 8; *(f32x4*)rowp = acc[ai][0][m][0]; *(f32x4*)(rowp + 4) = acc[ai][0][m][1]; }
            }
        }
    }
};
struct EpiOut {
    static constexpr bool PERM = true, AFTER_DRAIN = true;
    const float* X; float* OUT; bf16_t* X1B; float* SS;
    __device__ __forceinline__ void fused(f32x4 (&acc)[2][2][4][2], const Unit& u, int wr, int wc, int fr, int fq, PG8_LAS unsigned char* lds, int wid, int lane) const {
        PG8_LAS float* P = (PG8_LAS float*)lds;
        const int col0 = u.pn * BM + wc * 64 + 8 * fq;
#pragma unroll
        for (int ai = 0; ai < 2; ++ai)
#pragma unroll
            for (int m = 0; m < 4; ++m) { const int rl = ai * HALF + wr * 64 + m * 16 + fr; const size_t off = (size_t)(u.pm * BM + rl) * 1024 + col0; float ss = 0.f;
#pragma unroll
                for (int bj = 0; bj < 2; ++bj) { const f32x4 x0 = *(const f32x4*)(X + off + bj * 32), x1 = *(const f32x4*)(X + off + bj * 32 + 4);
                    const f32x4 v0 = acc[ai][bj][m][0] + x0, v1 = acc[ai][bj][m][1] + x1;
                    *(f32x4*)(OUT + off + bj * 32) = v0; *(f32x4*)(OUT + off + bj * 32 + 4) = v1; *(u32x4*)(X1B + off + bj * 32) = pack8(v0, v1);
                    ss += dot4(v0) + dot4(v1); }
                ss += __shfl_xor(ss, 16); ss += __shfl_xor(ss, 32);
                if (fq == 0) P[rl * 4 + wc] = ss; }
        asm volatile("s_waitcnt lgkmcnt(0)" ::: "memory"); __builtin_amdgcn_s_barrier(); asm volatile("" ::: "memory");
        const int t = wid * 64 + lane;
        if (t < 256) { const float s = (P[t * 4 + 0] + P[t * 4 + 1]) + (P[t * 4 + 2] + P[t * 4 + 3]); SS[(size_t)u.pn * 16384 + u.pm * BM + t] = s; }
    }
};
struct EpiUp {
    static constexpr bool PERM = true, AFTER_DRAIN = false;
    bf16_t* H; const float* SS; float eps;
    __device__ __forceinline__ void operator()(const f32x4 (&acc)[2][2][4][2], const Unit& u, int wr, int wc, int fr, int fq) const {
        const int row0 = u.pm * BM + wr * 64 + fr; bf16_t* base = H + u.pn * BM + wc * 64 + 8 * fq;
#pragma unroll
        for (int ai = 0; ai < 2; ++ai)
#pragma unroll
            for (int m = 0; m < 4; ++m) { const int row = row0 + ai * HALF + m * 16;
                const float s = (SS[row] + SS[16384 + row]) + (SS[32768 + row] + SS[49152 + row]); const float rs = 1.f / sqrtf(s * (1.f / 1024.f) + eps);
                bf16_t* rowp = base + (size_t)row * 4096;
#pragma unroll
                for (int bj = 0; bj < 2; ++bj) { f32x4 v0 = acc[ai][bj][m][0] * rs, v1 = acc[ai][bj][m][1] * rs;
#pragma unroll
                    for (int e = 0; e < 4; ++e) { v0[e] = fmaxf(v0[e], 0.f); v0[e] *= v0[e]; v1[e] = fmaxf(v1[e], 0.f); v1[e] *= v1[e]; }
                    *(u32x4*)(rowp + bj * 32) = pack8(v0, v1); } }
    }
};
struct EpiDown {
    static constexpr bool PERM = true, AFTER_DRAIN = false;
    float* OUT;
    __device__ __forceinline__ void operator()(const f32x4 (&acc)[2][2][4][2], const Unit& u, int wr, int wc, int fr, int fq) const {
        const int row0 = u.pm * BM + wr * 64 + fr; float* base = OUT + u.pn * BM + wc * 64 + 8 * fq;
#pragma unroll
        for (int ai = 0; ai < 2; ++ai)
#pragma unroll
            for (int m = 0; m < 4; ++m) { float* rowp = base + (size_t)(row0 + ai * HALF + m * 16) * 1024;
#pragma unroll
                for (int bj = 0; bj < 2; ++bj) { const f32x4 x0 = *(const f32x4*)(rowp + bj * 32), x1 = *(const f32x4*)(rowp + bj * 32 + 4);
                    *(f32x4*)(rowp + bj * 32) = x0 + acc[ai][bj][m][0]; *(f32x4*)(rowp + bj * 32 + 4) = x1 + acc[ai][bj][m][1]; } }
    }
};
template <class Epi, class Sched, bool ALIGN_EPI = false, bool SP2 = false>
__device__ __forceinline__ void gemm_phase(PG8_LAS unsigned char* lds, const Gemm g, const Sched& S, const Epi& E) {
    int tid_ = threadIdx.x; asm volatile("" : "+v"(tid_));
    const int tid = tid_, wid = __builtin_amdgcn_readfirstlane(tid >> 6), lane = tid & 63, wr = wid >> 2, wc = wid & 3, fr = lane & 15, fq = lane >> 4;
    const int K = g.K, nt = K / BK;
    unsigned voffA[2], voffB[2];
#pragma unroll
    for (int i = 0; i < 2; ++i) { int R, C; stage_rc(tid * 16 + i * 8192, R, C); const int Rb = 64 * (R >> 5) + (Epi::PERM ? perm32(R & 31) : (R & 31));
        voffA[i] = (unsigned)(R * K + C) * 2u; voffB[i] = (unsigned)(Rb * K + C) * 2u; }
    const size_t kstep = (size_t)(BK * 2);
    const size_t hstep = (size_t)HALF * K * 2;
    const size_t tstep = 2 * hstep; const size_t bhstep = (size_t)32 * K * 2;
    const unsigned ldsw = (unsigned)wid * 1024u;
    const int aoff = lds_byte(wr * 64 + fr, fq * 8), boff = lds_byte(wc * 32 + fr, fq * 8);
#define PG8_SA(b, h) (((b) * 2 + (h)) * HTB)
#define PG8_SB(b, h) ((4 + (b) * 2 + (h)) * HTB)
#define PG8_STAGE(bufoff, gbase, voff) do { _Pragma("unroll") for (int _i = 0; _i < 2; ++_i) \
        __builtin_amdgcn_global_load_lds((const unsigned*)((const char*)(gbase) + (voff)[_i]), (PG8_LAS unsigned*)(lds + (bufoff) + ldsw + _i * 8192), 16, 0, 0); } while (0)
#define PG8_LDA(dst, b, h) do { _Pragma("unroll") for (int m = 0; m < 4; ++m) _Pragma("unroll") for (int k = 0; k < 2; ++k) dst[m][k] = *(const PG8_LAS bf16x8*)(lds + PG8_SA(b, h) + aoff + m * 2048 + k * 1024); } while (0)
#define PG8_LDB(dst, b, h) do { _Pragma("unroll") for (int n = 0; n < 2; ++n) _Pragma("unroll") for (int k = 0; k < 2; ++k) dst[n][k] = *(const PG8_LAS bf16x8*)(lds + PG8_SB(b, h) + boff + n * 2048 + k * 1024); } while (0)
#define PG8_MMA(ai, bj, At, Bt) do { __builtin_amdgcn_s_setprio(1); _Pragma("unroll") for (int m = 0; m < 4; ++m) _Pragma("unroll") for (int n = 0; n < 2; ++n) _Pragma("unroll") for (int k = 0; k < 2; ++k) \
        acc[ai][bj][m][n] = __builtin_amdgcn_mfma_f32_16x16x32_bf16(Bt[n][k], At[m][k], acc[ai][bj][m][n], 0, 0, 0); __builtin_amdgcn_s_setprio(0); } while (0)
#define PG8_WAIT_V(n) asm volatile("s_waitcnt vmcnt(" #n ")" ::: "memory")
#define PG8_WAIT_L(n) asm volatile("s_waitcnt lgkmcnt(" #n ")" ::: "memory")
#define PG8_BAR __builtin_amdgcn_s_barrier()
#define PG8_SCHED __builtin_amdgcn_sched_barrier(0)
    Unit cur, nxt; int ui = 0;
    if (!S.next(0, cur)) return;
    f32x4 acc[2][2][4][2];
#pragma unroll
    for (int a = 0; a < 2; ++a)
#pragma unroll
        for (int b = 0; b < 2; ++b)
#pragma unroll
            for (int m = 0; m < 4; ++m)
#pragma unroll
                for (int n = 0; n < 2; ++n) acc[a][b][m][n] = (f32x4){0.f, 0.f, 0.f, 0.f};
    bf16x8 At[4][2], B0[2][2], B1[2][2];
    const char* cA = (const char*)g.A + (size_t)cur.pm * tstep; const char* cB = (const char*)g.Bt + (size_t)cur.pn * tstep;
    S.a_ready(cur);
    if constexpr (SP2) {
        PG8_STAGE(PG8_SB(0, 0), cB, voffB); PG8_STAGE(PG8_SB(0, 1), cB + bhstep, voffB); PG8_STAGE(PG8_SA(0, 0), cA, voffA); PG8_STAGE(PG8_SA(0, 1), cA + hstep, voffA);
        if (wr == 1) PG8_BAR;
        PG8_WAIT_V(2); PG8_BAR;
        PG8_STAGE(PG8_SB(1, 0), cB + kstep, voffB); PG8_STAGE(PG8_SA(1, 0), cA + kstep, voffA); PG8_STAGE(PG8_SB(1, 1), cB + bhstep + kstep, voffB);
        PG8_WAIT_V(6); PG8_BAR;
    } else {
        PG8_STAGE(PG8_SB(0, 0), cB, voffB); PG8_STAGE(PG8_SA(0, 0), cA, voffA); PG8_STAGE(PG8_SB(0, 1), cB + bhstep, voffB); PG8_STAGE(PG8_SA(0, 1), cA + hstep, voffA);
        if (wr == 1) PG8_BAR;
        PG8_WAIT_V(4); PG8_BAR;
        PG8_STAGE(PG8_SB(1, 0), cB + kstep, voffB); PG8_STAGE(PG8_SA(1, 0), cA + kstep, voffA); PG8_STAGE(PG8_SB(1, 1), cB + bhstep + kstep, voffB);
        PG8_WAIT_V(6); PG8_BAR;
    }
    for (;;) {
        const bool has_next = S.next(ui + 1, nxt);
        const char* nA = has_next ? (const char*)g.A + (size_t)nxt.pm * tstep : cA; const char* nB = has_next ? (const char*)g.Bt + (size_t)nxt.pn * tstep : cB;
        for (int t = 0; t < nt; t += 2) {
            const bool last = (t == nt - 2);
            const char* a1 = cA + (size_t)(t + 1) * kstep;
            const char* a2 = last ? nA : cA + (size_t)(t + 2) * kstep; const char* b2 = last ? nB : cB + (size_t)(t + 2) * kstep;
            const char* a3 = a2 + kstep; const char* b3 = b2 + kstep;
            if (last && has_next) S.a_ready(nxt);
            if constexpr (SP2) {
            PG8_LDB(B0, 0, 0); PG8_LDB(B1, 0, 1); PG8_SCHED; PG8_LDA(At, 0, 0); PG8_STAGE(PG8_SA(1, 1), a1 + hstep, voffA);
            PG8_WAIT_V(8); PG8_WAIT_L(0); PG8_BAR; PG8_MMA(0, 0, At, B0); PG8_MMA(0, 1, At, B1); PG8_BAR; PG8_SCHED;
            PG8_LDA(At, 0, 1); PG8_STAGE(PG8_SB(0, 0), b2, voffB); PG8_STAGE(PG8_SB(0, 1), b2 + bhstep, voffB); PG8_STAGE(PG8_SA(0, 0), a2, voffA);
            PG8_WAIT_V(8); PG8_WAIT_L(0); PG8_BAR; PG8_MMA(1, 0, At, B0); PG8_MMA(1, 1, At, B1); PG8_BAR; PG8_SCHED;
            PG8_LDB(B0, 1, 0); PG8_LDB(B1, 1, 1); PG8_SCHED; PG8_LDA(At, 1, 0); PG8_STAGE(PG8_SA(0, 1), a2 + hstep, voffA);
            PG8_WAIT_V(8); PG8_WAIT_L(0); PG8_BAR; PG8_MMA(0, 0, At, B0); PG8_MMA(0, 1, At, B1); PG8_BAR; PG8_SCHED;
            PG8_LDA(At, 1, 1); PG8_STAGE(PG8_SB(1, 0), b3, voffB); PG8_STAGE(PG8_SB(1, 1), b3 + bhstep, voffB); PG8_STAGE(PG8_SA(1, 0), a3, voffA);
            PG8_WAIT_V(8); PG8_WAIT_L(0); PG8_BAR; PG8_MMA(1, 0, At, B0); PG8_MMA(1, 1, At, B1); PG8_BAR; PG8_SCHED;
            } else {
            PG8_LDB(B0, 0, 0); PG8_SCHED; PG8_LDA(At, 0, 0); PG8_STAGE(PG8_SA(1, 1), a1 + hstep, voffA);
            PG8_WAIT_L(8); PG8_BAR; PG8_WAIT_L(0); PG8_MMA(0, 0, At, B0); PG8_BAR; PG8_SCHED;
            PG8_LDB(B1, 0, 1); PG8_STAGE(PG8_SB(0, 0), b2, voffB);
            PG8_BAR; PG8_WAIT_L(0); PG8_MMA(0, 1, At, B1); PG8_BAR;
            PG8_LDA(At, 0, 1); PG8_STAGE(PG8_SA(0, 0), a2, voffA);
            PG8_BAR; PG8_WAIT_L(0); PG8_MMA(1, 0, At, B0); PG8_BAR; PG8_SCHED;
            PG8_STAGE(PG8_SB(0, 1), b2 + bhstep, voffB);
            PG8_WAIT_V(6); PG8_BAR; PG8_MMA(1, 1, At, B1); PG8_BAR;
            PG8_LDB(B0, 1, 0); PG8_SCHED; PG8_LDA(At, 1, 0); PG8_STAGE(PG8_SA(0, 1), a2 + hstep, voffA);
            PG8_WAIT_L(8); PG8_BAR; PG8_WAIT_L(0); PG8_MMA(0, 0, At, B0); PG8_BAR; PG8_SCHED;
            PG8_LDB(B1, 1, 1); PG8_STAGE(PG8_SB(1, 0), b3, voffB);
            PG8_BAR; PG8_WAIT_L(0); PG8_MMA(0, 1, At, B1); PG8_BAR;
            PG8_LDA(At, 1, 1); PG8_STAGE(PG8_SA(1, 0), a3, voffA);
            PG8_BAR; PG8_WAIT_L(0); PG8_MMA(1, 0, At, B0); PG8_BAR; PG8_SCHED;
            PG8_STAGE(PG8_SB(1, 1), b3 + bhstep, voffB);
            PG8_WAIT_V(6); PG8_BAR; PG8_MMA(1, 1, At, B1); PG8_BAR;
            }
        }
        if constexpr (ALIGN_EPI) { if (wr == 0) PG8_BAR; }
        if constexpr (!Epi::AFTER_DRAIN) { E(acc, cur, wr, wc, fr, fq); S.done(cur); }
        if (!has_next) break;
#pragma unroll
        for (int a = 0; a < 2; ++a)
#pragma unroll
            for (int b = 0; b < 2; ++b)
#pragma unroll
                for (int m = 0; m < 4; ++m)
#pragma unroll
                    for (int n = 0; n < 2; ++n) acc[a][b][m][n] = (f32x4){0.f, 0.f, 0.f, 0.f};
        cur = nxt; cA = nA; cB = nB; ++ui;
        if constexpr (ALIGN_EPI) { if (wr == 1) PG8_BAR; }
    }
    PG8_WAIT_V(0);
    if constexpr (!ALIGN_EPI) { if (wr == 0) PG8_BAR; }
    PG8_BAR;
    if constexpr (Epi::AFTER_DRAIN) { E.fused(acc, cur, wr, wc, fr, fq, lds, wid, lane); S.done(cur); }
#undef PG8_SA
#undef PG8_SB
#undef PG8_STAGE
#undef PG8_LDA
#undef PG8_LDB
#undef PG8_MMA
#undef PG8_WAIT_V
#undef PG8_WAIT_L
#undef PG8_BAR
#undef PG8_SCHED
}
}
#define GAS __attribute__((address_space(1)))
#define LAS __attribute__((address_space(3)))
typedef unsigned short bf16;
typedef unsigned v4u __attribute__((ext_vector_type(4)));
typedef float f32x4 __attribute__((ext_vector_type(4)));
typedef short bf16x8 __attribute__((ext_vector_type(8)));
typedef GAS unsigned gu32;
typedef GAS unsigned long long gu64;
#define RLX_AGENT __ATOMIC_RELAXED, __HIP_MEMORY_SCOPE_AGENT
#define LDS_WAIT() asm volatile("s_waitcnt lgkmcnt(0)" ::: "memory")
#define VM_WAIT() asm volatile("s_waitcnt vmcnt(0)" ::: "memory")
__device__ __forceinline__ unsigned long long rt() { return __builtin_amdgcn_s_memrealtime(); }
__device__ __forceinline__ unsigned f2bf(float f) { unsigned u = __builtin_bit_cast(unsigned, f); return (u + 0x7fffu + ((u >> 16) & 1u)) >> 16; }
__device__ __forceinline__ unsigned pk2(float lo, float hi) { return f2bf(lo) | (f2bf(hi) << 16); }

#define XB_TMO      128
#define XB_XCNT(j)  (256  + 64 * (j))
#define XB_XSUB(j)  (1280 + 64 * (j))
#define XB_XGEN(j)  (2304 + 64 * (j))
#define XB_TOP      3328
#define XB_TOPGEN   3392
#define XCD_BAR_WORDS 3456
#define XB_SPIN_CAP (1u << 18)

__device__ __forceinline__ unsigned xb_ld(unsigned* p)              { return __hip_atomic_load(p, __ATOMIC_RELAXED, __HIP_MEMORY_SCOPE_AGENT); }
__device__ __forceinline__ unsigned xb_add(unsigned* p, unsigned v) { return __hip_atomic_fetch_add(p, v, __ATOMIC_RELAXED, __HIP_MEMORY_SCOPE_AGENT); }
__device__ __forceinline__ unsigned xb_xcc_id() { return (unsigned)__builtin_amdgcn_s_getreg((3 << 11) | 20) & 0xFu; }
#define XB_SPIN(cond, bar) do { unsigned _sp = 0; while (cond) { __builtin_amdgcn_s_sleep(1); \
    if ((++_sp & 255u) == 0u) { if (xb_ld(&(bar)[XB_TMO])) break; if (_sp > XB_SPIN_CAP) { atomicAdd(&(bar)[XB_TMO], 1u); break; } } } } while (0)

struct XcdBarrier {
    unsigned* bar; unsigned x;
    volatile LAS unsigned* st;
};

__device__ __forceinline__ XcdBarrier xcd_barrier_post(unsigned* bar, volatile LAS unsigned* st) {
    XcdBarrier b; b.bar = bar; b.x = xb_xcc_id(); b.st = st;
    if (threadIdx.x == 0) (void)xb_add(&bar[XB_XCNT(b.x)], 1u);
    return b;
}
__device__ __forceinline__ void xcd_barrier_complete(unsigned* bar, unsigned x, unsigned& nloc, unsigned& nx) {
    const unsigned G = gridDim.x * gridDim.y * gridDim.z;
    unsigned sum, cnt, mine, sp = 0u;
    for (;;) {
        sum = 0u; cnt = 0u; mine = 0u;
#pragma unroll
        for (unsigned j = 0; j < 16; ++j) { const unsigned c = xb_ld(&bar[XB_XCNT(j)]); sum += c; cnt += (c > 0u) ? 1u : 0u; mine = (j == x) ? c : mine; }
        if (sum == G) break;
        __builtin_amdgcn_s_sleep(1);
        if ((++sp & 255u) == 0u) { if (xb_ld(&bar[XB_TMO])) break; if (sp > XB_SPIN_CAP) { atomicAdd(&bar[XB_TMO], 1u); break; } }
    }
    nloc = mine > 0u ? mine : 1u; nx = cnt > 0u ? cnt : 1u;
}

__device__ __forceinline__ void xcd_barrier(const XcdBarrier& b) {
    asm volatile("s_waitcnt vmcnt(0)" ::: "memory");
    __syncthreads();
    if (threadIdx.x == 0) {
        unsigned* bar = b.bar;
        __builtin_amdgcn_s_waitcnt(0);
        unsigned nloc = b.st[0], nx = b.st[1];
        if (nloc == 0u) { xcd_barrier_complete(bar, b.x, nloc, nx); b.st[0] = nloc; b.st[1] = nx; }
        const unsigned old = xb_add(&bar[XB_XSUB(b.x)], 1u);
        const unsigned gen = old / nloc;
        if (old + 1u == (gen + 1u) * nloc) {
            __builtin_amdgcn_fence(__ATOMIC_RELEASE, "agent");
            asm volatile("s_waitcnt vmcnt(0)" ::: "memory");
            const unsigned og = xb_add(&bar[XB_TOP], 1u);
            const unsigned tg = og / nx;
            if (og + 1u == (tg + 1u) * nx) xb_add(&bar[XB_TOPGEN], 1u);
            else XB_SPIN(xb_ld(&bar[XB_TOPGEN]) == tg, bar);
            __builtin_amdgcn_fence(__ATOMIC_ACQUIRE, "agent");
            xb_add(&bar[XB_XGEN(b.x)], 1u);
            asm volatile("s_waitcnt vmcnt(0)" ::: "memory");
        } else {
            XB_SPIN(xb_ld(&bar[XB_XGEN(b.x)]) == gen, bar);
            __builtin_amdgcn_fence(__ATOMIC_ACQUIRE, "agent");
            asm volatile("s_waitcnt vmcnt(0)" ::: "memory");
        }
    }
    __syncthreads();
}


constexpr int NWAVES = 8;
constexpr int BATCH = 2, T = 8192, D = 1024, FF = 4096, M = BATCH * T;
constexpr int NIN = 3592, NINP = 3840;
constexpr int NCH = T / 64;
constexpr float EPS = 1e-6f;
constexpr float C2 = 0.125f * 1.4426950408889634f;
constexpr float LAM_INIT = 0.2f;

constexpr size_t MiB = 1u << 20;
constexpr size_t WS_CTL = 0, CTL_ZERO_BYTES = 1 * MiB;
constexpr size_t WS_WIN = 1 * MiB;
constexpr size_t WS_WOUT = 9 * MiB;
constexpr size_t WS_WUP = 11 * MiB;
constexpr size_t WS_WDN = 19 * MiB;
constexpr size_t WS_AB = 27 * MiB;
constexpr size_t WS_G = WS_AB + 512 * 1024;
constexpr size_t WS_BETA = WS_G + 256 * 1024;
constexpr size_t WS_SS = 28 * MiB;
constexpr size_t WS_EGL = WS_SS + 256 * 1024;
constexpr size_t WS_XN = 30 * MiB;
constexpr size_t WS_UT = 30 * MiB;
constexpr size_t WS_QK = 46 * MiB;
constexpr size_t WS_QA = 62 * MiB, WS_KA = 78 * MiB, WS_VA = 94 * MiB, WS_Z = 110 * MiB;
constexpr size_t WS_DNRAW = 126 * MiB;
constexpr size_t WS_W = 126 * MiB, WS_KD = 142 * MiB, WS_QE = 158 * MiB;
constexpr size_t WS_DNE = 174 * MiB;
constexpr size_t WS_SC = 174 * MiB;
constexpr size_t WS_VN = 206 * MiB;
constexpr size_t WS_MIX = 222 * MiB;
constexpr size_t WS_H = 62 * MiB;
constexpr size_t WS_END = 256 * MiB;
static_assert(WS_MIX + (size_t)M * 1024 * 2 <= WS_END && WS_H + (size_t)M * FF * 2 <= WS_MIX && WS_EGL + 4096 <= WS_XN, "d_ws map");
constexpr int CW_BAR = 4096;
constexpr int CW_ATTQ = 16384;

constexpr int RING_OFF = 0, RING_BYTES = 131072;
constexpr int LDSCTL_OFF = RING_BYTES, MISC_OFF = LDSCTL_OFF + 320;
constexpr int WSF_OFF = LDSCTL_OFF + 1024;
constexpr int LDS_BYTES = 147456;

typedef short s16x4 __attribute__((ext_vector_type(4)));
typedef float f32x16 __attribute__((ext_vector_type(16)));
typedef float f32x2 __attribute__((ext_vector_type(2)));
enum { I_X = 0, I_NORM1 = 1, I_WIN = 2, I_LQ1 = 3, I_LK1 = 4, I_LQ2 = 5, I_LK2 = 6, I_QNW = 7, I_KNW = 8, I_DAOW = 9, I_CONVW = 10, I_ALOG = 11, I_DTB = 12, I_DNOW = 13, I_WOUT = 14, I_NORM2 = 15, I_WUP = 16, I_WDOWN = 17 };
struct Frame {
    LAS unsigned char* lds;
    volatile LAS unsigned* MISC;
    gu32* ctl;
    int tid, lane, wave;
    int vcu, G;
    unsigned char* ws;
    const float* const __attribute__((address_space(4)))* in;
    float* out;
};
__device__ __forceinline__ float wave_sum(float v) {
#pragma unroll
    for (int o = 1; o < 64; o <<= 1) v += __shfl_xor(v, o);
    return v;
}
__device__ __forceinline__ float dot4f(const f32x4 a) { return (a[0] * a[0] + a[1] * a[1]) + (a[2] * a[2] + a[3] * a[3]); }
__device__ __forceinline__ float bf2f(unsigned short b) { return __builtin_bit_cast(float, (unsigned)b << 16); }
__device__ __forceinline__ float bflo(unsigned w) { return __builtin_bit_cast(float, w << 16); }
__device__ __forceinline__ float bfhi(unsigned w) { return __builtin_bit_cast(float, w & 0xffff0000u); }
__device__ __forceinline__ int perm16(int p) { return (p & ~12) | ((p & 4) << 1) | ((p & 8) >> 1); }
__device__ __forceinline__ int crow(int r, int hi) { return (r & 3) + 8 * (r >> 2) + 4 * hi; }
__device__ __forceinline__ unsigned cvtpk(float lo, float hi) { f32x2 v = {lo, hi}; typedef __bf16 bf2 __attribute__((ext_vector_type(2))); bf2 b = __builtin_convertvector(v, bf2); return __builtin_bit_cast(unsigned, b); }
__device__ __forceinline__ bf16x8 pack_f8(const f32x16& p, int b) { v4u w; w.x = cvtpk(p[b], p[b + 1]); w.y = cvtpk(p[b + 2], p[b + 3]); w.z = cvtpk(p[b + 4], p[b + 5]); w.w = cvtpk(p[b + 6], p[b + 7]); return __builtin_bit_cast(bf16x8, w); }
#define MFMA32(a, b, c) __builtin_amdgcn_mfma_f32_32x32x16_bf16(a, b, c, 0, 0, 0)
__device__ __forceinline__ void glds16(const void* gsrc, unsigned lds_dst) { unsigned keep;
    asm volatile("s_mov_b32 %0, m0\n\ts_mov_b32 m0, %2\n\ts_nop 0\n\tglobal_load_lds_dwordx4 %1, off\n\ts_mov_b32 m0, %0" : "=&s"(keep) : "v"(gsrc), "s"(lds_dst) : "memory"); }

__device__ __forceinline__ void p0_transpose_item(const float* W, int K, int N, bf16* WT, const float* kscale, LAS float* scr, int item, int lane) {
    const int nblk = (N + 31) / 32, kb = item / nblk, nb = item % nblk, k0 = 64 * kb, n0 = 32 * nb;
#pragma unroll 8
    for (int i = 0; i < 32; ++i) { const int kk = 2 * i + (lane >> 5), n = n0 + (lane & 31); float v = 0.f; if (n < N) v = W[(size_t)(k0 + kk) * N + n]; if (kscale) v *= kscale[k0 + kk]; scr[kk * 33 + (lane & 31)] = v; }
    LDS_WAIT(); asm volatile("" ::: "memory");
    const int c = lane & 7;
#pragma unroll
    for (int j = 0; j < 4; ++j) { const int n = (lane >> 3) + 8 * j; const LAS float* s = scr + (8 * c) * 33 + n;
        v4u o; o.x = pk2(s[0 * 33], s[1 * 33]); o.y = pk2(s[2 * 33], s[3 * 33]); o.z = pk2(s[4 * 33], s[5 * 33]); o.w = pk2(s[6 * 33], s[7 * 33]);
        *(GAS v4u*)(WT + (size_t)(n0 + n) * K + k0 + 8 * c) = o; }
    LDS_WAIT(); asm volatile("" ::: "memory");
}
__device__ __forceinline__ void p0_prologue(Frame& F) {
    LAS float* scr = (LAS float*)(F.lds + RING_OFF + F.wave * 16384);
    const int gw = F.vcu * NWAVES + F.wave, NGW = F.G * NWAVES;
    bf16* Win = (bf16*)(F.ws + WS_WIN); bf16* Wout = (bf16*)(F.ws + WS_WOUT); bf16* Wup = (bf16*)(F.ws + WS_WUP); bf16* Wdn = (bf16*)(F.ws + WS_WDN);
    constexpr int I_IN = (D / 64) * ((NIN + 31) / 32), I_OUT = (D / 64) * (D / 32), I_UP = (D / 64) * (FF / 32), I_DN = (FF / 64) * (D / 32);
    constexpr int NITEMS = I_IN + I_OUT + I_UP + I_DN;
    for (int it = gw; it < NITEMS; it += NGW) {
        int r = it;
        if (r < I_IN) { p0_transpose_item(F.in[I_WIN], D, NIN, Win, nullptr, scr, r, F.lane); continue; } r -= I_IN;
        if (r < I_OUT) { p0_transpose_item(F.in[I_WOUT], D, D, Wout, nullptr, scr, r, F.lane); continue; } r -= I_OUT;
        if (r < I_UP) { p0_transpose_item(F.in[I_WUP], D, FF, Wup, F.in[I_NORM2], scr, r, F.lane); continue; } r -= I_UP;
        p0_transpose_item(F.in[I_WDOWN], FF, D, Wdn, nullptr, scr, r, F.lane);
    }
    { constexpr int R0 = ((NIN + 31) / 32) * 32; GAS v4u* z = (GAS v4u*)(Win + (size_t)R0 * D); const int n16 = (NINP - R0) * D * 2 / 16;
      for (int i = gw * 64 + F.lane; i < n16; i += NGW * 64) z[i] = (v4u){0u, 0u, 0u, 0u}; }
    bf16* XN = (bf16*)(F.ws + WS_XN); const float* xin = F.in[I_X]; const float* n1w = F.in[I_NORM1];
    for (int m = gw; m < M; m += NGW) {
        const GAS f32x4* xr = (const GAS f32x4*)(xin + (size_t)m * D) + F.lane; const GAS f32x4* wr4 = (const GAS f32x4*)n1w + F.lane;
        f32x4 v[4]; float s = 0.f;
#pragma unroll
        for (int j = 0; j < 4; ++j) { v[j] = xr[64 * j]; s += dot4f(v[j]); }
        const float rs = 1.f / sqrtf(wave_sum(s) * (1.f / D) + EPS);
        GAS unsigned long long* o8 = (GAS unsigned long long*)(XN + (size_t)m * D) + F.lane;
#pragma unroll
        for (int j = 0; j < 4; ++j) { const f32x4 w = wr4[64 * j]; o8[64 * j] = (unsigned long long)pk2(v[j].x * rs * w.x, v[j].y * rs * w.y) | ((unsigned long long)pk2(v[j].z * rs * w.z, v[j].w * rs * w.w) << 32); }
    }
}

__device__ __forceinline__ float silu_f(float v) { return v / (1.f + __expf(-v)); }
__device__ __forceinline__ void p2_dn_elementwise(Frame& F) {
    const bf16* RAW = (const bf16*)(F.ws + WS_DNRAW); bf16* DNE = (bf16*)(F.ws + WS_DNE);
    const float* AB = (const float*)(F.ws + WS_AB); float* G = (float*)(F.ws + WS_G); float* BETA = (float*)(F.ws + WS_BETA);
    const int gw = F.vcu * NWAVES + F.wave, NGW = F.G * NWAVES, lane = F.lane;
    const float* convw = F.in[I_CONVW]; const float* dtb = F.in[I_DTB]; const float* alog = F.in[I_ALOG];
    constexpr int RUN = 8;
    for (int task = gw; task < M / RUN; task += NGW) {
        const int row0 = task * RUN, t0 = row0 % T;
        for (int sec = 0; sec < 3; ++sec) {
            const int ch = sec * 512 + 8 * lane;
            float cw[4][8];
#pragma unroll
            for (int j = 0; j < 4; ++j) { const f32x4 a = *(const f32x4*)(convw + j * 1536 + ch), b = *(const f32x4*)(convw + j * 1536 + ch + 4);
                cw[j][0] = a.x; cw[j][1] = a.y; cw[j][2] = a.z; cw[j][3] = a.w; cw[j][4] = b.x; cw[j][5] = b.y; cw[j][6] = b.z; cw[j][7] = b.w; }
            v4u win[3];
#pragma unroll
            for (int j = 0; j < 3; ++j) { const int tt = t0 - 3 + j; win[j] = (v4u){0u, 0u, 0u, 0u}; if (tt >= 0) win[j] = *(const GAS v4u*)(RAW + (size_t)(row0 - 3 + j) * 1536 + ch); }
#pragma unroll
            for (int i = 0; i < RUN; ++i) {
                const v4u cur = *(const GAS v4u*)(RAW + (size_t)(row0 + i) * 1536 + ch);
                float y[8];
#pragma unroll
                for (int e = 0; e < 4; ++e) {
                    const unsigned w0 = win[0][e], w1 = win[1][e], w2 = win[2][e], w3 = cur[e];
                    float lo = cw[0][2 * e] * bflo(w0) + cw[1][2 * e] * bflo(w1) + cw[2][2 * e] * bflo(w2) + cw[3][2 * e] * bflo(w3);
                    float hi = cw[0][2 * e + 1] * bfhi(w0) + cw[1][2 * e + 1] * bfhi(w1) + cw[2][2 * e + 1] * bfhi(w2) + cw[3][2 * e + 1] * bfhi(w3);
                    y[2 * e] = silu_f(lo); y[2 * e + 1] = silu_f(hi);
                }
                float sc = 1.f;
                if (sec < 2) { float ss = 0.f;
#pragma unroll
                    for (int e = 0; e < 8; ++e) ss += y[e] * y[e];
                    ss += __shfl_xor(ss, 1); ss += __shfl_xor(ss, 2); ss += __shfl_xor(ss, 4); ss += __shfl_xor(ss, 8);
                    sc = 1.f / sqrtf(ss + EPS); if (sec == 0) sc *= 0.08838834764831845f; }
                v4u o; o.x = cvtpk(y[0] * sc, y[1] * sc); o.y = cvtpk(y[2] * sc, y[3] * sc); o.z = cvtpk(y[4] * sc, y[5] * sc); o.w = cvtpk(y[6] * sc, y[7] * sc);
                *(GAS v4u*)(DNE + (size_t)(row0 + i) * 1536 + ch) = o;
                win[0] = win[1]; win[1] = win[2]; win[2] = cur;
            }
        }
        { const int i = lane >> 3, sl = lane & 7, row = row0 + i; const float v = AB[(size_t)row * 8 + sl];
          if (sl < 4) { const float xx = v + dtb[sl]; const float sp = xx > 20.f ? xx : log1pf(__expf(xx)); G[(size_t)row * 4 + sl] = -__expf(alog[sl]) * sp; }
          else BETA[(size_t)row * 4 + (sl - 4)] = 1.f / (1.f + __expf(-v)); }
    }
}

constexpr int LT_STRIDE = 68, P3_TS = 136;
constexpr int P3_SMALL = 64 * LT_STRIDE * 4, P3_TILES = P3_SMALL + 1024;
__device__ __forceinline__ void p3_chunk_prep(Frame& F) {
    const bf16* DNE = (const bf16*)(F.ws + WS_DNE); const float* G = (const float*)(F.ws + WS_G); const float* BETA = (const float*)(F.ws + WS_BETA);
    bf16* Wg = (bf16*)(F.ws + WS_W); bf16* KD = (bf16*)(F.ws + WS_KD); bf16* QE = (bf16*)(F.ws + WS_QE); bf16* UT = (bf16*)(F.ws + WS_UT); bf16* QK = (bf16*)(F.ws + WS_QK); float* EGL = (float*)(F.ws + WS_EGL);
    LAS float* Lt = (LAS float*)(F.lds + RING_OFF);
    LAS float* gcs = (LAS float*)(F.lds + RING_OFF + P3_SMALL);
    LAS float* bts = gcs + 64; LAS float* egc = gcs + 128; LAS float* edl = gcs + 192;
    LAS bf16* Tq = (LAS bf16*)(F.lds + RING_OFF + P3_TILES); LAS bf16* Tk = Tq + 64 * P3_TS; LAS bf16* Tv = Tk + 64 * P3_TS;
    LAS float* Xs = (LAS float*)(F.lds + RING_OFF + P3_TILES + 3 * 64 * P3_TS * 2);
    static_assert(P3_TILES + 3 * 64 * P3_TS * 2 + 48 * 256 * 4 <= RING_BYTES, "P3 LDS");
    const int tid = F.tid, lane = F.lane, wave = F.wave, r32 = lane & 31, hi = lane >> 5;
    for (int unit = F.vcu; unit < 8 * NCH; unit += F.G) {
        const int bh = unit >> 7, c = unit & 127, b = bh >> 2, h = bh & 3; const size_t row0 = (size_t)b * T + (size_t)c * 64;
#pragma unroll
        for (int i = 0; i < 6; ++i) { const int pc = tid + 512 * i, sec = pc >> 10, rr = (pc >> 4) & 63, ch = pc & 15;
            const v4u v = *(const GAS v4u*)(DNE + (row0 + rr) * 1536 + sec * 512 + h * 128 + ch * 8);
            *(LAS v4u*)(Tq + sec * 64 * P3_TS + rr * P3_TS + ch * 8) = v; }
        if (wave == 0) {
            float g = G[(row0 + lane) * 4 + h]; const float bt = BETA[(row0 + lane) * 4 + h];
#pragma unroll
            for (int o = 1; o < 64; o <<= 1) { const float t = __shfl_up(g, o); if (lane >= o) g += t; }
            const float glast = __shfl(g, 63);
            gcs[lane] = g; bts[lane] = bt; egc[lane] = __expf(g); edl[lane] = __expf(glast - g);
            if (lane == 63) EGL[unit] = __expf(g);
        }
        __syncthreads();
        {
            const int mat = wave >> 2, ti = (wave >> 1) & 1, tj = wave & 1;
            const LAS bf16* Ar = (mat == 0 ? Tk : Tq) + (32 * ti + r32) * P3_TS + 8 * hi;
            const LAS bf16* Br = Tk + (32 * tj + r32) * P3_TS + 8 * hi;
            f32x16 acc = {};
#pragma unroll
            for (int s = 0; s < 8; ++s) { const bf16x8 a = *(const LAS bf16x8*)(Ar + 16 * s), bb = *(const LAS bf16x8*)(Br + 16 * s); acc = MFMA32(a, bb, acc); }
            const int j = 32 * tj + r32; const float gj = gcs[j];
#pragma unroll
            for (int r = 0; r < 16; ++r) { const int i = 32 * ti + crow(r, hi); const float dec = __expf(fminf(gcs[i] - gj, 0.f)); const float lv = bts[i] * acc[r] * dec, qv = acc[r] * dec;
                if (mat == 0) Lt[j * LT_STRIDE + i] = lv;
                else { const unsigned keep = ~(unsigned)((i - j) >> 31);
                    QK[(size_t)unit * 4096 + i * 64 + perm16(j)] = (bf16)f2bf(__uint_as_float(__float_as_uint(qv) & keep)); } }
        }
        __syncthreads();
        if (tid < 256) {
            const bool isw = tid >= 128; const int cc = tid & 127;
            const LAS bf16* src = (isw ? Tk : Tv) + cc;
#pragma unroll
            for (int bi = 0; bi < 4; ++bi) {
                float xr[16];
#pragma unroll
                for (int i = 0; i < 16; ++i) { const int t = 16 * bi + i; xr[i] = bf2f(src[t * P3_TS]) * bts[t] * (isw ? egc[t] : 1.f); }
                if (bi > 0) {
#pragma unroll 2
                    for (int j = 0; j < 16 * bi; ++j) { const float xj = Xs[j * 256 + tid]; const LAS f32x4* lp = (const LAS f32x4*)(Lt + j * LT_STRIDE + 16 * bi);
#pragma unroll
                        for (int k = 0; k < 4; ++k) { const f32x4 l = lp[k]; xr[4 * k + 0] -= l[0] * xj; xr[4 * k + 1] -= l[1] * xj; xr[4 * k + 2] -= l[2] * xj; xr[4 * k + 3] -= l[3] * xj; } }
                }
#pragma unroll
                for (int j = 0; j < 15; ++j) { const float xj = xr[j]; const LAS f32x4* lp = (const LAS f32x4*)(Lt + (16 * bi + j) * LT_STRIDE + 16 * bi);
#pragma unroll
                    for (int k = ((j + 1) >> 2); k < 4; ++k) { const f32x4 l = lp[k];
#pragma unroll
                        for (int e = 0; e < 4; ++e) if (4 * k + e > j) xr[4 * k + e] -= l[e] * xj; } }
                if (bi < 3) {
#pragma unroll
                    for (int i = 0; i < 16; ++i) Xs[(16 * bi + i) * 256 + tid] = xr[i];
                }
                if (!isw) {
                    GAS v4u* o = (GAS v4u*)(UT + ((size_t)unit * 128 + cc) * 64 + 32 * (bi >> 1) + 8 * (bi & 1));
#pragma unroll
                    for (int hh = 0; hh < 2; ++hh) { v4u w; w.x = cvtpk(xr[4 * hh], xr[4 * hh + 1]); w.y = cvtpk(xr[4 * hh + 2], xr[4 * hh + 3]); w.z = cvtpk(xr[8 + 4 * hh], xr[9 + 4 * hh]); w.w = cvtpk(xr[10 + 4 * hh], xr[11 + 4 * hh]); o[2 * hh] = w; }
                } else {
                    bf16* o = Wg + (size_t)unit * 8192 + (size_t)(16 * bi) * 128 + perm16(cc);
#pragma unroll
                    for (int i = 0; i < 16; ++i) o[i * 128] = (bf16)f2bf(xr[i]);
                }
            }
        } else if (tid < 384) {
            const int dk = tid - 256; const LAS bf16* src = Tk + dk;
            GAS v4u* o = (GAS v4u*)(KD + ((size_t)unit * 128 + dk) * 64);
#pragma unroll
            for (int q = 0; q < 8; ++q) { v4u w;
#pragma unroll
                for (int e2 = 0; e2 < 4; ++e2) { const int p = 8 * q + 2 * e2, t0 = (p & ~12) | ((p & 4) << 1) | ((p & 8) >> 1);
                    w[e2] = cvtpk(bf2f(src[t0 * P3_TS]) * edl[t0], bf2f(src[(t0 + 1) * P3_TS]) * edl[t0 + 1]); }
                o[q] = w; }
        } else {
            const int dk = tid - 384; const LAS bf16* src = Tq + dk; bf16* o = QE + (size_t)unit * 8192 + perm16(dk);
#pragma unroll 8
            for (int t = 0; t < 64; ++t) o[t * 128] = (bf16)f2bf(bf2f(src[t * P3_TS]) * egc[t]);
        }
        __syncthreads();
    }
}

#define ASM_WAIT_V(n) asm volatile("s_waitcnt vmcnt(" #n ")" ::: "memory")
__device__ __forceinline__ unsigned lds_addr(LAS unsigned char* p) { return (unsigned)(uintptr_t)p; }
__device__ __forceinline__ void p4_scan(Frame& F, int bh) {
    const bf16* Wg = (const bf16*)(F.ws + WS_W); const bf16* KD = (const bf16*)(F.ws + WS_KD); const bf16* UT = (const bf16*)(F.ws + WS_UT); const float* EGL = (const float*)(F.ws + WS_EGL);
    bf16* SC = (bf16*)(F.ws + WS_SC); bf16* VN = (bf16*)(F.ws + WS_VN);
    const int wave = F.wave, lane = F.lane, r32 = lane & 31, hi = lane >> 5;
    LAS unsigned char* ring = F.lds + RING_OFF; const unsigned lds0 = lds_addr(ring);
    const bool loader = wave >= 4; const int lw = wave & 3;
#define SCAN_ISSUE(c_, slot_) do { const bf16* Wc_ = Wg + ((size_t)(bh * NCH + (c_))) * 8192; const bf16* Kc_ = KD + ((size_t)(bh * NCH + (c_))) * 8192; const unsigned sb_ = lds0 + (unsigned)(slot_) * 32768u; \
        _Pragma("unroll") for (int k_ = 0; k_ < 4; ++k_) { const int q_ = lw + 4 * k_; glds16(Wc_ + lane * 128 + q_ * 8, (unsigned)__builtin_amdgcn_readfirstlane(sb_ + q_ * 1024)); } \
        _Pragma("unroll") for (int k_ = 0; k_ < 4; ++k_) { const int i_ = lw + 4 * k_, q_ = i_ >> 1, h_ = i_ & 1; glds16(Kc_ + (64 * h_ + lane) * 64 + q_ * 8, (unsigned)__builtin_amdgcn_readfirstlane(sb_ + 16384 + q_ * 2048 + h_ * 1024)); } } while (0)
    f32x16 S[4]; S[0] = f32x16{}; S[1] = f32x16{}; S[2] = f32x16{}; S[3] = f32x16{};
    v4u un[2][2];
    if (loader) { SCAN_ISSUE(0, 0); SCAN_ISSUE(1, 1); }
    else {
        const GAS v4u* up = (const GAS v4u*)(UT + ((size_t)(bh * NCH) * 128 + 32 * wave + r32) * 64 + 16 * hi);
        un[0][0] = up[0]; un[0][1] = up[1]; un[1][0] = up[4]; un[1][1] = up[5];
    }
    int slot = 0;
    for (int c = 0; c < NCH; ++c) {
        if (loader) { if (c + 1 < NCH) ASM_WAIT_V(8); else ASM_WAIT_V(0); }
        asm volatile("s_waitcnt lgkmcnt(0)" ::: "memory"); __builtin_amdgcn_s_barrier(); asm volatile("" ::: "memory");
        if (loader) { if (c + 2 < NCH) { const int s2 = slot >= 1 ? slot - 1 : 2; SCAN_ISSUE(c + 2, s2); } }
        else {
            const size_t unit = (size_t)bh * NCH + c; const int wv = wave;
            LAS unsigned char* Wimg = ring + slot * 32768; LAS unsigned char* Kimg = Wimg + 16384;
            const float dec = EGL[unit];
            v4u uc[2][2]; uc[0][0] = un[0][0]; uc[0][1] = un[0][1]; uc[1][0] = un[1][0]; uc[1][1] = un[1][1];
            if (c + 1 < NCH) { const GAS v4u* up = (const GAS v4u*)(UT + ((unit + 1) * 128 + 32 * wv + r32) * 64 + 16 * hi); un[0][0] = up[0]; un[0][1] = up[1]; un[1][0] = up[4]; un[1][1] = up[5]; }
            bf16x8 Sf[4][2];
#pragma unroll
            for (int kt = 0; kt < 4; ++kt)
#pragma unroll
                for (int s = 0; s < 2; ++s) { Sf[kt][s] = pack_f8(S[kt], 8 * s); *(GAS bf16x8*)(SC + (((unit * 4 + wv) * 8 + kt * 2 + s) * 64 + lane) * 8) = Sf[kt][s]; }
            f32x16 P[2]; P[0] = f32x16{}; P[1] = f32x16{};
#pragma unroll
            for (int kt = 0; kt < 4; ++kt)
#pragma unroll
                for (int s = 0; s < 2; ++s)
#pragma unroll
                    for (int tt = 0; tt < 2; ++tt) { const bf16x8 a = *(const LAS bf16x8*)(Wimg + (4 * kt + 2 * s + hi) * 1024 + (32 * tt + r32) * 16); P[tt] = MFMA32(a, Sf[kt][s], P[tt]); }
#pragma unroll
            for (int kt = 0; kt < 4; ++kt) S[kt] = S[kt] * dec;
            bf16x8 Vf[2][2];
#pragma unroll
            for (int tt = 0; tt < 2; ++tt) { f32x16 vn;
#pragma unroll
                for (int e = 0; e < 4; ++e) { vn[2 * e] = bflo(uc[tt][0][e]) - P[tt][2 * e]; vn[2 * e + 1] = bfhi(uc[tt][0][e]) - P[tt][2 * e + 1]; vn[8 + 2 * e] = bflo(uc[tt][1][e]) - P[tt][8 + 2 * e]; vn[8 + 2 * e + 1] = bfhi(uc[tt][1][e]) - P[tt][8 + 2 * e + 1]; }
#pragma unroll
                for (int s = 0; s < 2; ++s) { Vf[tt][s] = pack_f8(vn, 8 * s); *(GAS bf16x8*)(VN + (((unit * 4 + wv) * 4 + tt * 2 + s) * 64 + lane) * 8) = Vf[tt][s]; } }
#pragma unroll
            for (int tt = 0; tt < 2; ++tt)
#pragma unroll
                for (int s = 0; s < 2; ++s)
#pragma unroll
                    for (int kt = 0; kt < 4; ++kt) { const bf16x8 a = *(const LAS bf16x8*)(Kimg + (4 * tt + 2 * s + hi) * 2048 + (32 * kt + r32) * 16); S[kt] = MFMA32(a, Vf[tt][s], S[kt]); }
        }
        slot = slot == 2 ? 0 : slot + 1;
    }
    asm volatile("s_waitcnt vmcnt(0) lgkmcnt(0)" ::: "memory"); __builtin_amdgcn_s_barrier(); asm volatile("" ::: "memory");
#undef SCAN_ISSUE
}

__device__ __forceinline__ float max3f(float a, float b, float c) { return fmaxf(fmaxf(a, b), c); }
__device__ __forceinline__ s16x4 vtr(const LAS unsigned char* p) { typedef short v4i16_t __attribute__((ext_vector_type(4))); return __builtin_bit_cast(s16x4, __builtin_amdgcn_ds_read_tr16_b64_v4i16((LAS v4i16_t*)p)); }
__device__ __forceinline__ void attn_unit(Frame& F, int bh, int qb, float lam) {
    const bf16* QA = (const bf16*)(F.ws + WS_QA); const bf16* KA = (const bf16*)(F.ws + WS_KA); const bf16* VA = (const bf16*)(F.ws + WS_VA); bf16* MIX = (bf16*)(F.ws + WS_MIX);
    const int wave = F.wave, lane = F.lane, r32 = lane & 31, hi = lane >> 5, mp = wave >> 2, wq = wave & 3;
    const int b = bh >> 2, h = bh & 3; const size_t rowb = (size_t)b * T; const int q0 = qb * 128, NT = 2 * (qb + 1);
    LAS unsigned char* ring = F.lds + RING_OFF; const unsigned lds0 = lds_addr(ring);
    LAS float* wsf = (LAS float*)(F.lds + WSF_OFF) + wave * 64;
    LAS float* XCH = (LAS float*)(ring + 65536);
    const bf16* Kh = KA + rowb * 512 + h * 128; const bf16* Vh = VA + rowb * 512 + h * 128;
    bf16x8 qr[4];
    { const bf16* Qw = QA + (rowb + q0 + 32 * wq + r32) * 512 + h * 128 + mp * 64 + 8 * hi;
#pragma unroll
      for (int d0 = 0; d0 < 4; ++d0) qr[d0] = *(const GAS bf16x8*)(Qw + 16 * d0); }
    asm volatile("s_waitcnt vmcnt(0)" ::: "memory");
#define ATT_DMA(t_, slot_) do { const unsigned sb_ = lds0 + (unsigned)(slot_) * 32768u; \
        _Pragma("unroll") for (int k_ = 0; k_ < 2; ++k_) { const int ch_ = wave + 8 * k_; glds16(Kh + ((size_t)(t_) * 64 + lane) * 512 + ch_ * 8, (unsigned)__builtin_amdgcn_readfirstlane(sb_ + ch_ * 1024)); } \
        _Pragma("unroll") for (int k_ = 0; k_ < 2; ++k_) { const int p_ = wave + 8 * k_, d0_ = p_ >> 2, rg_ = p_ & 3; glds16(Vh + ((size_t)(t_) * 64 + 16 * rg_ + (lane >> 2)) * 512 + d0_ * 32 + (lane & 3) * 8, (unsigned)__builtin_amdgcn_readfirstlane(sb_ + 16384 + p_ * 1024)); } } while (0)
    ATT_DMA(0, 0);
    float m_run = -INFINITY, l_run = 0.f;
    f32x16 o[4]; o[0] = f32x16{}; o[1] = f32x16{}; o[2] = f32x16{}; o[3] = f32x16{};
    const int qpos = q0 + 32 * wq + r32;
    for (int t = 0; t < NT; ++t) {
        if (t + 1 < NT) { ATT_DMA(t + 1, (t + 1) & 1); ASM_WAIT_V(4); } else ASM_WAIT_V(0);
        __builtin_amdgcn_s_barrier(); asm volatile("" ::: "memory");
        const LAS unsigned char* Kimg = ring + (t & 1) * 32768; const LAS unsigned char* Vimg = Kimg + 16384;
        f32x16 p0 = f32x16{}, p1 = f32x16{};
#pragma unroll
        for (int d0 = 0; d0 < 4; ++d0) { const LAS unsigned char* kb = Kimg + (8 * mp + 2 * d0 + hi) * 1024 + r32 * 16;
            const bf16x8 b0 = *(const LAS bf16x8*)kb, b1 = *(const LAS bf16x8*)(kb + 512);
            p0 = MFMA32(b0, qr[d0], p0); p1 = MFMA32(b1, qr[d0], p1); }
        if (t >= NT - 2) {
#pragma unroll
            for (int r = 0; r < 16; ++r) { const int kv = 64 * t + crow(r, hi); if (kv > qpos) p0[r] = -INFINITY; if (kv + 32 > qpos) p1[r] = -INFINITY; }
        }
        float rm = max3f(p0[0], p0[1], p1[0]); rm = max3f(rm, p1[1], p0[2]);
#pragma unroll
        for (int r = 2; r < 16; ++r) rm = max3f(rm, p0[r], p1[r]);
        { auto rr = __builtin_amdgcn_permlane32_swap(__float_as_uint(rm), __float_as_uint(rm), false, false); rm = fmaxf(__uint_as_float(rr[0]), __uint_as_float(rr[1])); }
        const float m_new = fmaxf(m_run, rm); const float alpha = __builtin_amdgcn_exp2f(m_run - m_new); m_run = m_new;
        float rs = 0.f;
#pragma unroll
        for (int r = 0; r < 16; ++r) { p0[r] = __builtin_amdgcn_exp2f(p0[r] - m_new); p1[r] = __builtin_amdgcn_exp2f(p1[r] - m_new); rs += p0[r] + p1[r]; }
        l_run = l_run * alpha + rs;
        if (hi == 0) wsf[r32] = alpha;
        asm volatile("s_waitcnt lgkmcnt(0)" ::: "memory");
        float al[16];
#pragma unroll
        for (int r = 0; r < 16; ++r) al[r] = wsf[crow(r, hi)];
#pragma unroll
        for (int d0 = 0; d0 < 4; ++d0)
#pragma unroll
            for (int r = 0; r < 16; ++r) o[d0][r] *= al[r];
        bf16x8 pa[4]; pa[0] = pack_f8(p0, 0); pa[1] = pack_f8(p0, 8); pa[2] = pack_f8(p1, 0); pa[3] = pack_f8(p1, 8);
        const LAS unsigned char* vb = Vimg + (4 * hi + ((lane & 15) >> 2)) * 64 + ((lane >> 4) & 1) * 32 + (lane & 3) * 8;
#pragma unroll
        for (int d0 = 0; d0 < 4; ++d0)
#pragma unroll
            for (int ks = 0; ks < 4; ++ks) { const s16x4 lo = vtr(vb + d0 * 4096 + ks * 1024), hh = vtr(vb + d0 * 4096 + ks * 1024 + 512);
                const bf16x8 vf = (bf16x8){lo[0], lo[1], lo[2], lo[3], hh[0], hh[1], hh[2], hh[3]}; o[d0] = MFMA32(pa[ks], vf, o[d0]); }
        asm volatile("s_waitcnt lgkmcnt(0)" ::: "memory"); __builtin_amdgcn_s_barrier(); asm volatile("" ::: "memory");
    }
#undef ATT_DMA
    { auto rr = __builtin_amdgcn_permlane32_swap(__float_as_uint(l_run), __float_as_uint(l_run), false, false); l_run = __uint_as_float(rr[0]) + __uint_as_float(rr[1]); }
    if (hi == 0) wsf[32 + r32] = 1.f / l_run;
    asm volatile("s_waitcnt lgkmcnt(0)" ::: "memory");
    float rl[16];
#pragma unroll
    for (int r = 0; r < 16; ++r) rl[r] = wsf[32 + crow(r, hi)];
    if (mp == 1) {
#pragma unroll
        for (int d0 = 0; d0 < 4; ++d0)
#pragma unroll
            for (int r = 0; r < 16; ++r) XCH[((wq * 4 + d0) * 16 + r) * 64 + lane] = o[d0][r] * rl[r];
    }
    asm volatile("s_waitcnt lgkmcnt(0)" ::: "memory"); __builtin_amdgcn_s_barrier(); asm volatile("" ::: "memory");
    if (mp == 0) {
        float ss[16];
#pragma unroll
        for (int r = 0; r < 16; ++r) ss[r] = 0.f;
#pragma unroll
        for (int d0 = 0; d0 < 4; ++d0)
#pragma unroll
            for (int r = 0; r < 16; ++r) { const float v = o[d0][r] * rl[r] - lam * XCH[((wq * 4 + d0) * 16 + r) * 64 + lane]; o[d0][r] = v; ss[r] += v * v; }
#pragma unroll
        for (int r = 0; r < 16; ++r) { float s = ss[r]; s += __shfl_xor(s, 1); s += __shfl_xor(s, 2); s += __shfl_xor(s, 4); s += __shfl_xor(s, 8); s += __shfl_xor(s, 16); ss[r] = (1.f - LAM_INIT) / sqrtf(s * (1.f / 128.f) + EPS); }
#pragma unroll
        for (int d0 = 0; d0 < 4; ++d0) { const float w = F.in[I_DAOW][32 * d0 + r32];
#pragma unroll
            for (int r = 0; r < 16; ++r) MIX[(rowb + q0 + 32 * wq + crow(r, hi)) * 1024 + h * 128 + 32 * d0 + r32] = (bf16)f2bf(o[d0][r] * ss[r] * w); }
    }
    asm volatile("s_waitcnt lgkmcnt(0)" ::: "memory"); __builtin_amdgcn_s_barrier(); asm volatile("" ::: "memory");
}
__device__ __forceinline__ void p4_attention(Frame& F) {
    float lam;
    { const float a = wave_sum(F.in[I_LQ1][F.lane] * F.in[I_LK1][F.lane]), bq = wave_sum(F.in[I_LQ2][F.lane] * F.in[I_LK2][F.lane]); lam = expf(a) - expf(bq) + LAM_INIT; }
    const int x0 = (int)(blockIdx.x & 7);
    for (int k = 0; k < 8; ++k) { const int q = (x0 + k) & 7;
        for (;;) {
            if (F.tid == 0) F.MISC[0] = __hip_atomic_fetch_add(F.ctl + CW_ATTQ + 64 * q, 1u, RLX_AGENT);
            __syncthreads(); const unsigned i = F.MISC[0]; __syncthreads();
            if (i >= 64u) break;
            attn_unit(F, q, 63 - (int)i, lam);
        }
    }
}

__device__ __forceinline__ void p5_dn_out(Frame& F) {
    const bf16* QE = (const bf16*)(F.ws + WS_QE); const bf16* QK = (const bf16*)(F.ws + WS_QK); const bf16* SC = (const bf16*)(F.ws + WS_SC); const bf16* VN = (const bf16*)(F.ws + WS_VN);
    const bf16* Z = (const bf16*)(F.ws + WS_Z); bf16* MIX = (bf16*)(F.ws + WS_MIX);
    LAS float* part = (LAS float*)(F.lds + RING_OFF);
    const int wave = F.wave, lane = F.lane, r32 = lane & 31, hi = lane >> 5, tt = wave >> 2, wv = wave & 3;
    for (int unit = F.vcu; unit < 8 * NCH; unit += F.G) {
        const int bh = unit >> 7, c = unit & 127, b = bh >> 2, h = bh & 3; const size_t row0 = (size_t)b * T + (size_t)c * 64;
        f32x16 acc = f32x16{};
        const bf16* a1 = QE + (size_t)unit * 8192 + (32 * tt + r32) * 128 + 8 * hi; const bf16* b1 = SC + (((size_t)unit * 4 + wv) * 8 * 64 + lane) * 8;
#pragma unroll
        for (int ks = 0; ks < 8; ++ks) { const bf16x8 a = *(const GAS bf16x8*)(a1 + 16 * ks), bb = *(const GAS bf16x8*)(b1 + ks * 512); acc = MFMA32(a, bb, acc); }
        const bf16* a2 = QK + (size_t)unit * 4096 + (32 * tt + r32) * 64 + 8 * hi; const bf16* b2 = VN + (((size_t)unit * 4 + wv) * 4 * 64 + lane) * 8;
#pragma unroll
        for (int ks = 0; ks < 4; ++ks) { const bf16x8 a = *(const GAS bf16x8*)(a2 + 16 * ks), bb = *(const GAS bf16x8*)(b2 + ks * 512); acc = MFMA32(a, bb, acc); }
#pragma unroll
        for (int r = 0; r < 16; ++r) { float s = acc[r] * acc[r]; s += __shfl_xor(s, 1); s += __shfl_xor(s, 2); s += __shfl_xor(s, 4); s += __shfl_xor(s, 8); s += __shfl_xor(s, 16);
            if (r32 == 0) part[(32 * tt + crow(r, hi)) * 4 + wv] = s; }
        __syncthreads();
        const int dv = 32 * wv + r32; const float w = F.in[I_DNOW][dv];
#pragma unroll
        for (int r = 0; r < 16; ++r) { const int tok = 32 * tt + crow(r, hi); const f32x4 pp = *(const LAS f32x4*)(part + tok * 4);
            const float rms = 1.f / sqrtf(((pp[0] + pp[1]) + (pp[2] + pp[3])) * (1.f / 128.f) + EPS);
            const float z = bf2f(Z[(row0 + tok) * 512 + h * 128 + dv]);
            MIX[(row0 + tok) * 1024 + 512 + h * 128 + dv] = (bf16)f2bf(acc[r] * rms * w * silu_f(z)); }
        __syncthreads();
    }
}

struct Args { const float* in[18]; float* out; unsigned char* ws; };
__global__ void __launch_bounds__(NWAVES * 64, 2) hymba_fwd(Args args) {
    extern __shared__ __attribute__((aligned(16))) unsigned char lds[];
    Frame F;
    F.lds = (LAS unsigned char*)lds;
    F.MISC = (volatile LAS unsigned*)(F.lds + MISC_OFF);
    F.tid = threadIdx.x; F.lane = F.tid & 63; F.wave = __builtin_amdgcn_readfirstlane(F.tid >> 6);
    F.G = gridDim.x; { const int bx = blockIdx.x; F.vcu = (F.G % 8 == 0) ? (bx % 8) * (F.G / 8) + bx / 8 : bx; }
    F.ws = args.ws; F.ctl = (gu32*)(args.ws + WS_CTL); F.out = args.out;
    F.in = (const float* const __attribute__((address_space(4)))*)__builtin_amdgcn_kernarg_segment_ptr();
    for (int u = F.tid; u < (LDS_BYTES - LDSCTL_OFF) / 4; u += NWAVES * 64) ((LAS unsigned*)(F.lds + LDSCTL_OFF))[u] = 0u;
    __syncthreads();
    XcdBarrier bar = xcd_barrier_post((unsigned*)(F.ctl + CW_BAR), F.MISC + 8);
#define GRID_BAR() xcd_barrier(bar)
    typedef pg8::bf16_t pbf;
#ifndef PH_MASK
#define PH_MASK 0x3ff
#endif
    if constexpr (PH_MASK & 1) p0_prologue(F);
    GRID_BAR();
    if constexpr (PH_MASK & 2) {   pg8::Gemm g{(const pbf*)(F.ws + WS_XN), (const pbf*)(F.ws + WS_WIN), M, NINP, D}; pg8::StaticOrder S; S.init(M, NINP, F.G, (int)blockIdx.x);
        pg8::EpiProj E{(pbf*)(F.ws + WS_QA), (pbf*)(F.ws + WS_KA), (pbf*)(F.ws + WS_VA), (pbf*)(F.ws + WS_DNRAW), (pbf*)(F.ws + WS_Z), (float*)(F.ws + WS_AB), F.in[I_QNW], F.in[I_KNW], C2, EPS};
        pg8::gemm_phase<pg8::EpiProj, pg8::StaticOrder, true, true>(F.lds + RING_OFF, g, S, E); }
    GRID_BAR();
    if constexpr (PH_MASK & 4) p2_dn_elementwise(F);
    GRID_BAR();
    if constexpr (PH_MASK & 8) p3_chunk_prep(F);
    GRID_BAR();
    if constexpr (PH_MASK & 16) { if (blockIdx.x < 8) p4_scan(F, (int)blockIdx.x); }
    if constexpr (PH_MASK & 0x200) p4_attention(F);
    GRID_BAR();
    if constexpr (PH_MASK & 32) p5_dn_out(F);
    GRID_BAR();
    if constexpr (PH_MASK & 64) {   pg8::Gemm g{(const pbf*)(F.ws + WS_MIX), (const pbf*)(F.ws + WS_WOUT), M, D, D}; pg8::StaticOrder S; S.init(M, D, F.G, (int)blockIdx.x);
        pg8::EpiOut E{F.in[I_X], F.out, (pbf*)(F.ws + WS_XN), (float*)(F.ws + WS_SS)};
        pg8::gemm_phase<pg8::EpiOut, pg8::StaticOrder, false, true>(F.lds + RING_OFF, g, S, E); }
    GRID_BAR();
    if constexpr (PH_MASK & 128) {   pg8::Gemm g{(const pbf*)(F.ws + WS_XN), (const pbf*)(F.ws + WS_WUP), M, FF, D}; pg8::StaticOrder S; S.init(M, FF, F.G, (int)blockIdx.x);
        pg8::EpiUp E{(pbf*)(F.ws + WS_H), (const float*)(F.ws + WS_SS), EPS};
        pg8::gemm_phase<pg8::EpiUp, pg8::StaticOrder, true, true>(F.lds + RING_OFF, g, S, E); }
    GRID_BAR();
    if constexpr (PH_MASK & 256) {   pg8::Gemm g{(const pbf*)(F.ws + WS_H), (const pbf*)(F.ws + WS_WDN), M, D, FF}; pg8::StaticOrder S; S.init(M, D, F.G, (int)blockIdx.x);
        pg8::EpiDown E{F.out};
        pg8::gemm_phase<pg8::EpiDown, pg8::StaticOrder, false, true>(F.lds + RING_OFF, g, S, E); }
}

extern "C" void kernel_launch(void* const* d_in, const int* in_sizes, int n_in, void* d_out, int out_size, void* d_ws, size_t ws_size, hipStream_t stream) {
    static int grid = 0;
    if (grid == 0) {
        if (n_in != 18 || in_sizes[0] != M * D || out_size != M * D || ws_size < WS_END) { fprintf(stderr, "kernel_launch: unexpected shapes (n_in %d, in0 %d, out %d, ws %zu); nothing launched\n", n_in, n_in > 0 ? in_sizes[0] : -1, out_size, ws_size); grid = -1; return; }
        int dev = 0, cus = 0;
        if (hipGetDevice(&dev) != hipSuccess || hipDeviceGetAttribute(&cus, hipDeviceAttributeMultiprocessorCount, dev) != hipSuccess) { grid = -1; return; }
        if (hipFuncSetAttribute((const void*)hymba_fwd, hipFuncAttributeMaxDynamicSharedMemorySize, LDS_BYTES) != hipSuccess) { fprintf(stderr, "kernel_launch: hipFuncSetAttribute failed\n"); grid = -1; return; }
        (void)hipGetLastError();
        grid = cus;
        if (grid != 256) { fprintf(stderr, "kernel_launch: needs a 256-CU device (got %d)\n", grid); grid = -1; return; }
    }
    if (grid < 0) return;
    if (hipMemsetAsync((char*)d_ws + WS_CTL, 0, 131072, stream) != hipSuccess) return;
    Args a{};
    for (int i = 0; i < 18; ++i) a.in[i] = (const float*)d_in[i];
    a.out = (float*)d_out; a.ws = (unsigned char*)d_ws;
    hipLaunchKernelGGL(hymba_fwd, dim3(grid), dim3(NWAVES * 64), LDS_BYTES, stream, a);
}
```
